# Optimizing an MI355X kernel written in HIP

```python
import math
import jax, jax.numpy as jnp
from jax import lax
import numpy as np

D_MODEL = 1024
BATCH = 1
SEQ = 16384
DEPTH = 1

D_MIX = D_MODEL
CONV_WIDTH = D_MIX // 2
ATTN_WIDTH = D_MIX - CONV_WIDTH
DIFF_HEAD_DIM = 64
N_DIFF_HEADS = ATTN_WIDTH // (2 * DIFF_HEAD_DIM)
ROT_DIM = DIFF_HEAD_DIM // 4
ROPE_THETA = 500000.0
CONV_KERNEL = 31
D_FF = 2816
Q_BLOCK = 128
N_SUBLAYERS = 3
N_MOD = 3 * N_SUBLAYERS
IN_COLS = 2 * CONV_WIDTH + 3 * ATTN_WIDTH
ALPHA = (2.0 * DEPTH) ** 0.25
BETA = (8.0 * DEPTH) ** -0.25
LN_EPS = 1e-5

kernel_name = "hybrid_conformer_diffattn_macaron_deepnorm_adaln"


def layer_norm(x, g, b):
    xf = x.astype(jnp.float32)
    mu = jnp.mean(xf, axis=-1, keepdims=True)
    var = jnp.mean(jnp.square(xf - mu), axis=-1, keepdims=True)
    y = (xf - mu) * lax.rsqrt(var + LN_EPS)
    return (y * g.astype(jnp.float32) + b.astype(jnp.float32)).astype(x.dtype)


def rms_norm(x, g):
    xf = x.astype(jnp.float32)
    y = xf * lax.rsqrt(jnp.mean(jnp.square(xf), axis=-1, keepdims=True) + LN_EPS)
    return (y * g.astype(jnp.float32)).astype(x.dtype)


def swiglu(h, w_in, w_out):
    gate, up = jnp.split(h @ w_in, 2, axis=-1)
    return (jax.nn.silu(gate) * up) @ w_out


def partial_rope(t, cos, sin):
    rot, rest = t[..., :ROT_DIM], t[..., ROT_DIM:]
    r1, r2 = rot[..., :ROT_DIM // 2], rot[..., ROT_DIM // 2:]
    cos = cos.astype(t.dtype)[None, :, None, None, :]
    sin = sin.astype(t.dtype)[None, :, None, None, :]
    rot = jnp.concatenate([r1 * cos - r2 * sin, r2 * cos + r1 * sin], axis=-1)
    return jnp.concatenate([rot, rest], axis=-1)


def conformer_conv(glu_a, glu_b, conv_w, conv_b, ln_g, ln_b):
    u = glu_a * jax.nn.sigmoid(glu_b)
    pad = (CONV_KERNEL - 1) // 2
    u = lax.conv_general_dilated(
        u, conv_w[:, None, :].astype(u.dtype), window_strides=(1,),
        padding=[(pad, pad)], dimension_numbers=("NWC", "WIO", "NWC"),
        feature_group_count=CONV_WIDTH) + conv_b
    return jax.nn.silu(layer_norm(u, ln_g, ln_b))


def diff_attention(q, k, v, lq1, lk1, lq2, lk2, subln_g, cos, sin, lam_init):
    B, S, _ = q.shape
    H, Dh = N_DIFF_HEADS, DIFF_HEAD_DIM
    q = partial_rope(q.reshape(B, S, H, 2, Dh), cos, sin)
    k = partial_rope(k.reshape(B, S, H, 2, Dh), cos, sin)
    v = v.reshape(B, S, H, 2 * Dh).transpose(0, 2, 1, 3)
    q = q.transpose(0, 2, 3, 1, 4)
    k = k.transpose(0, 2, 3, 1, 4)
    lam = (jnp.exp(jnp.sum(lq1.astype(jnp.float32) * lk1.astype(jnp.float32)))
           - jnp.exp(jnp.sum(lq2.astype(jnp.float32) * lk2.astype(jnp.float32)))
           + lam_init)
    scale = 1.0 / math.sqrt(Dh)
    n_blk = S // Q_BLOCK
    q_blocks = jnp.moveaxis(q.reshape(B, H, 2, n_blk, Q_BLOCK, Dh), 3, 0)

    def attend(qb):
        s = jnp.einsum("bhmqd,bhmkd->bhmqk", qb, k).astype(jnp.float32) * scale
        p = jax.nn.softmax(s, axis=-1)
        a = p[:, :, 0] - lam * p[:, :, 1]
        return jnp.einsum("bhqk,bhkd->bhqd", a.astype(v.dtype), v)

    out = lax.map(attend, q_blocks)
    out = out.transpose(1, 0, 3, 2, 4).reshape(B, S, H, 2 * Dh)
    out = rms_norm(out, subln_g) * (1.0 - lam_init)
    return out.reshape(B, S, H * 2 * Dh)


def hybrid_mixer(h, w_in, conv_w, conv_b, conv_ln_g, conv_ln_b,
                 lq1, lk1, lq2, lk2, subln_g, w_out, cos, sin, lam_init):
    proj = h @ w_in
    c0 = CONV_WIDTH
    glu_a, glu_b, q, k, v = jnp.split(
        proj, [c0, 2 * c0, 2 * c0 + ATTN_WIDTH, 2 * c0 + 2 * ATTN_WIDTH], axis=-1)
    conv_out = conformer_conv(glu_a, glu_b, conv_w, conv_b, conv_ln_g, conv_ln_b)
    attn_out = diff_attention(q, k, v, lq1, lk1, lq2, lk2, subln_g, cos, sin, lam_init)
    return jnp.concatenate([conv_out, attn_out], axis=-1) @ w_out


def post_norm_sublayer(x, mod, weight, f, g, b):
    shift, scale, gate = mod[:, 0, None, :], mod[:, 1, None, :], mod[:, 2, None, :]
    y = f(x * (1.0 + scale) + shift)
    return layer_norm(ALPHA * x + weight * (1.0 + gate) * y, g, b)


def setup_inputs(seed: int = 0) -> dict:
    key = jax.random.key(seed)
    ks = jax.random.split(key, 32)
    L, D = DEPTH, D_MODEL

    def nrm(k, shape, s):
        return jax.random.normal(k, shape, jnp.float32) * s

    def gain(k, shape):
        return 1.0 + nrm(k, shape, 0.02)

    return {
        "x": nrm(ks[0], (BATCH, SEQ, D), 1.0),
        "c": nrm(ks[1], (BATCH, D), 1.0),
        "w_ada": nrm(ks[2], (L, D, N_MOD * D), 0.1 * D ** -0.5),
        "b_ada": nrm(ks[3], (L, N_MOD * D), 0.01),
        "ffn1_w_in": nrm(ks[4], (L, D, 2 * D_FF), D ** -0.5),
        "ffn1_w_out": nrm(ks[5], (L, D_FF, D), BETA * D_FF ** -0.5),
        "ln1_g": gain(ks[6], (L, D)),
        "ln1_b": nrm(ks[7], (L, D), 0.02),
        "mix_w_in": nrm(ks[8], (L, D, IN_COLS), D ** -0.5),
        "conv_w": nrm(ks[9], (L, CONV_KERNEL, CONV_WIDTH), CONV_KERNEL ** -0.5),
        "conv_b": nrm(ks[10], (L, CONV_WIDTH), 0.02),
        "conv_ln_g": gain(ks[11], (L, CONV_WIDTH)),
        "conv_ln_b": nrm(ks[12], (L, CONV_WIDTH), 0.02),
        "lambda_q1": nrm(ks[13], (L, DIFF_HEAD_DIM), 0.1),
        "lambda_k1": nrm(ks[14], (L, DIFF_HEAD_DIM), 0.1),
        "lambda_q2": nrm(ks[15], (L, DIFF_HEAD_DIM), 0.1),
        "lambda_k2": nrm(ks[16], (L, DIFF_HEAD_DIM), 0.1),
        "subln_g": gain(ks[17], (L, 2 * DIFF_HEAD_DIM)),
        "mix_w_out": nrm(ks[18], (L, D_MIX, D), BETA * D_MIX ** -0.5),
        "ln2_g": gain(ks[19], (L, D)),
        "ln2_b": nrm(ks[20], (L, D), 0.02),
        "ffn2_w_in": nrm(ks[21], (L, D, 2 * D_FF), D ** -0.5),
        "ffn2_w_out": nrm(ks[22], (L, D_FF, D), BETA * D_FF ** -0.5),
        "ln3_g": gain(ks[23], (L, D)),
        "ln3_b": nrm(ks[24], (L, D), 0.02),
    }


def reference(x, c, w_ada, b_ada, ffn1_w_in, ffn1_w_out, ln1_g, ln1_b,
              mix_w_in, conv_w, conv_b, conv_ln_g, conv_ln_b,
              lambda_q1, lambda_k1, lambda_q2, lambda_k2, subln_g, mix_w_out, ln2_g, ln2_b,
              ffn2_w_in, ffn2_w_out, ln3_g, ln3_b):
    B, S, D = x.shape
    pos = jnp.arange(S, dtype=jnp.float32)
    inv_freq = ROPE_THETA ** (-jnp.arange(0, ROT_DIM, 2, dtype=jnp.float32) / ROT_DIM)
    ang = pos[:, None] * inv_freq[None, :]
    cos, sin = jnp.cos(ang), jnp.sin(ang)
    c_act = jax.nn.silu(c)

    for l in range(DEPTH):
        lam_init = 0.8 - 0.6 * math.exp(-0.3 * l)
        mod = (c_act @ w_ada[l] + b_ada[l]).reshape(B, N_SUBLAYERS, 3, D)
        x = post_norm_sublayer(
            x, mod[:, 0], 0.5,
            lambda h: swiglu(h, ffn1_w_in[l], ffn1_w_out[l]), ln1_g[l], ln1_b[l])
        x = post_norm_sublayer(
            x, mod[:, 1], 1.0,
            lambda h: hybrid_mixer(h, mix_w_in[l], conv_w[l], conv_b[l], conv_ln_g[l], conv_ln_b[l],
                                   lambda_q1[l], lambda_k1[l], lambda_q2[l], lambda_k2[l],
                                   subln_g[l], mix_w_out[l], cos, sin, lam_init),
            ln2_g[l], ln2_b[l])
        x = post_norm_sublayer(
            x, mod[:, 2], 0.5,
            lambda h: swiglu(h, ffn2_w_in[l], ffn2_w_out[l]), ln3_g[l], ln3_b[l])
    return x
```

```cpp
#include <hip/hip_runtime.h>
#include <cstdio>
#include <cstdint>

typedef unsigned short bf16_t;
constexpr int S = 16384, D = 1024, FF = 2816, CW = 512, AW = 512, NMIX = 2560;
constexpr int NMOD = 9216;
constexpr float ALPHA = 1.189207115002721f;
constexpr float LN_EPS = 1e-5f;
constexpr float LAM_INIT = 0.2f;
constexpr float C2 = 0.125f * 1.4426950408889634f;

constexpr size_t MiB = 1u << 20;
constexpr size_t WS_MOD = 1 * MiB, WS_COS = 2 * MiB, WS_SIN = 2 * MiB + 512 * 1024;
constexpr size_t WS_H = 48 * MiB, WS_ACT = 80 * MiB;
constexpr size_t WS_U = 80 * MiB, WS_Q = 96 * MiB, WS_K = 112 * MiB, WS_V = 128 * MiB, WS_A2 = 144 * MiB;
constexpr size_t WS_NV = 176 * MiB;
constexpr size_t WS_END = 240 * MiB;

__device__ __forceinline__ unsigned f2bf(float f) { unsigned u = __float_as_uint(f); return (u + 0x7fffu + ((u >> 16) & 1u)) >> 16; }
__device__ __forceinline__ float bf2f(unsigned b) { return __uint_as_float(b << 16); }
__device__ __forceinline__ float silu_f(float x) { return x / (1.f + expf(-x)); }
__device__ __forceinline__ float sigmoid_f(float x) { return 1.f / (1.f + expf(-x)); }

__global__ __launch_bounds__(256) void k_mod(const float* __restrict__ c, const float* __restrict__ w, const float* __restrict__ b, float* __restrict__ mod) {
    const int n = blockIdx.x * 256 + threadIdx.x;
    float acc = 0.f;
    for (int k = 0; k < D; ++k) acc += silu_f(c[k]) * w[(size_t)k * NMOD + n];
    mod[n] = acc + b[n];
}
__global__ __launch_bounds__(256) void k_rope(float* __restrict__ ct, float* __restrict__ st) {
    const int idx = blockIdx.x * 256 + threadIdx.x;
    const int pos = idx >> 3, i = idx & 7;
    const float invf = powf(500000.0f, -(float)i * 0.125f);
    const float ang = (float)pos * invf;
    ct[idx] = (float)cos((double)ang); st[idx] = (float)sin((double)ang);
}
__global__ __launch_bounds__(256) void k_modulate(const float* __restrict__ x, const float* __restrict__ shift, const float* __restrict__ scale, bf16_t* __restrict__ H) {
    const size_t i = (size_t)blockIdx.x * 256 + threadIdx.x;
    const int c = (int)(i & (D - 1));
    H[i] = (bf16_t)f2bf(x[i] * (1.f + scale[c]) + shift[c]);
}

struct EpiSwiglu { bf16_t* act; __device__ void operator()(int r, int c, float g, float u) const { act[(size_t)r * FF + c] = (bf16_t)f2bf(silu_f(g) * u); } };
struct EpiGlu { bf16_t* U; __device__ void operator()(int r, int c, float a, float b) const { U[(size_t)r * CW + c] = (bf16_t)f2bf(a * sigmoid_f(b)); } };
struct EpiF32 { float* Y; int ld; int pad; __device__ void operator()(int r, int c, float v, float) const { Y[(size_t)r * ld + c] = v; } };
struct EpiBf { bf16_t* Y; int ld; int pad; __device__ void operator()(int r, int c, float v, float) const { Y[(size_t)r * ld + c] = (bf16_t)f2bf(v); } };

template <bool DUAL, class Epi>
__global__ __launch_bounds__(256) void gemm_naive(const bf16_t* __restrict__ A, int K, const float* __restrict__ W, int ldw, int wcol0, int col2_off, Epi epi) {
    __shared__ float As[16][65];
    __shared__ float Bs[16][64];
    __shared__ float Bs2[16][64];
    const int tid = threadIdx.x, tx = tid & 15, ty = tid >> 4;
    const int m0 = blockIdx.y * 64, n0 = blockIdx.x * 64;
    float acc[4][4], acc2[4][4];
#pragma unroll
    for (int i = 0; i < 4; ++i)
#pragma unroll
        for (int j = 0; j < 4; ++j) { acc[i][j] = 0.f; acc2[i][j] = 0.f; }
    for (int k0 = 0; k0 < K; k0 += 16) {
        { const int r = tid >> 2, kq = (tid & 3) * 4;
          const ushort4 v = *(const ushort4*)(A + (size_t)(m0 + r) * K + k0 + kq);
          As[kq + 0][r] = bf2f(v.x); As[kq + 1][r] = bf2f(v.y); As[kq + 2][r] = bf2f(v.z); As[kq + 3][r] = bf2f(v.w); }
        { const int kk = tid >> 4, n4 = (tid & 15) * 4;
          const float4 v = *(const float4*)(W + (size_t)(k0 + kk) * ldw + wcol0 + n0 + n4);
          Bs[kk][n4 + 0] = v.x; Bs[kk][n4 + 1] = v.y; Bs[kk][n4 + 2] = v.z; Bs[kk][n4 + 3] = v.w;
          if (DUAL) { const float4 w2 = *(const float4*)(W + (size_t)(k0 + kk) * ldw + wcol0 + col2_off + n0 + n4);
              Bs2[kk][n4 + 0] = w2.x; Bs2[kk][n4 + 1] = w2.y; Bs2[kk][n4 + 2] = w2.z; Bs2[kk][n4 + 3] = w2.w; } }
        __syncthreads();
#pragma unroll
        for (int kk = 0; kk < 16; ++kk) {
            float a[4], b[4], b2[4];
#pragma unroll
            for (int i = 0; i < 4; ++i) a[i] = As[kk][ty * 4 + i];
#pragma unroll
            for (int j = 0; j < 4; ++j) { b[j] = Bs[kk][tx * 4 + j]; b2[j] = DUAL ? Bs2[kk][tx * 4 + j] : 0.f; }
#pragma unroll
            for (int i = 0; i < 4; ++i)
#pragma unroll
                for (int j = 0; j < 4; ++j) { acc[i][j] += a[i] * b[j]; if (DUAL) acc2[i][j] += a[i] * b2[j]; }
        }
        __syncthreads();
    }
#pragma unroll
    for (int i = 0; i < 4; ++i)
#pragma unroll
        for (int j = 0; j < 4; ++j) epi(m0 + ty * 4 + i, n0 + tx * 4 + j, acc[i][j], acc2[i][j]);
}

__global__ __launch_bounds__(256) void k_ln(const float* xin, const float* __restrict__ y, const float* __restrict__ gate, float wgt,
                                            const float* __restrict__ g, const float* __restrict__ b, float* xout,
                                            const float* __restrict__ shift, const float* __restrict__ scale, bf16_t* __restrict__ H) {
    const int lane = threadIdx.x & 63, row = blockIdx.x * 4 + (threadIdx.x >> 6);
    float v[16]; float s = 0.f;
#pragma unroll
    for (int j = 0; j < 16; ++j) { const int c = j * 64 + lane; v[j] = ALPHA * xin[(size_t)row * D + c] + wgt * (1.f + gate[c]) * y[(size_t)row * D + c]; s += v[j]; }
#pragma unroll
    for (int o = 1; o < 64; o <<= 1) s += __shfl_xor(s, o);
    const float mean = s * (1.f / D); float q = 0.f;
#pragma unroll
    for (int j = 0; j < 16; ++j) { const float d = v[j] - mean; q += d * d; }
#pragma unroll
    for (int o = 1; o < 64; o <<= 1) q += __shfl_xor(q, o);
    const float rstd = 1.f / sqrtf(q * (1.f / D) + LN_EPS);
#pragma unroll
    for (int j = 0; j < 16; ++j) { const int c = j * 64 + lane; const float o = (v[j] - mean) * rstd * g[c] + b[c];
        xout[(size_t)row * D + c] = o; if (H) H[(size_t)row * D + c] = (bf16_t)f2bf(o * (1.f + scale[c]) + shift[c]); }
}

__global__ __launch_bounds__(256) void k_ropeqk(const float* __restrict__ pqk, const float* __restrict__ ct, const float* __restrict__ st, bf16_t* __restrict__ Q, bf16_t* __restrict__ Kb) {
    const size_t idx = (size_t)blockIdx.x * 256 + threadIdx.x;
    const int row = (int)(idx >> 10), c = (int)(idx & 1023), dd = c & 63;
    float v = pqk[idx];
    if (dd < 16) { const int i = dd & 7; const float cs = ct[row * 8 + i], sn = st[row * 8 + i];
        if (dd < 8) v = v * cs - pqk[idx + 8] * sn; else v = v * cs + pqk[idx - 8] * sn; }
    if (c < 512) Q[(size_t)row * 512 + c] = (bf16_t)f2bf(v * C2); else Kb[(size_t)row * 512 + (c - 512)] = (bf16_t)f2bf(v);
}

__global__ __launch_bounds__(256) void k_conv(const bf16_t* __restrict__ U, const float* __restrict__ cw, const float* __restrict__ cb,
                                              const float* __restrict__ g, const float* __restrict__ b, bf16_t* __restrict__ A2) {
    __shared__ float red[8];
    const int s = blockIdx.x, tid = threadIdx.x;
    float v[2];
#pragma unroll
    for (int e = 0; e < 2; ++e) { const int ch = tid + e * 256; float acc = cb[ch];
        for (int t = 0; t < 31; ++t) { const int p = s + t - 15; if (p >= 0 && p < S) acc += bf2f(U[(size_t)p * CW + ch]) * cw[t * CW + ch]; }
        v[e] = acc; }
    float sum = v[0] + v[1];
#pragma unroll
    for (int o = 1; o < 64; o <<= 1) sum += __shfl_xor(sum, o);
    if ((tid & 63) == 0) red[tid >> 6] = sum;
    __syncthreads();
    const float mean = (red[0] + red[1] + red[2] + red[3]) * (1.f / CW);
    float q = (v[0] - mean) * (v[0] - mean) + (v[1] - mean) * (v[1] - mean);
#pragma unroll
    for (int o = 1; o < 64; o <<= 1) q += __shfl_xor(q, o);
    if ((tid & 63) == 0) red[4 + (tid >> 6)] = q;
    __syncthreads();
    const float rstd = 1.f / sqrtf((red[4] + red[5] + red[6] + red[7]) * (1.f / CW) + LN_EPS);
#pragma unroll
    for (int e = 0; e < 2; ++e) { const int ch = tid + e * 256; const float y = (v[e] - mean) * rstd * g[ch] + b[ch];
        A2[(size_t)s * D + ch] = (bf16_t)f2bf(silu_f(y)); }
}

__global__ __launch_bounds__(256) void k_attn(const bf16_t* __restrict__ Q, const bf16_t* __restrict__ Kb, const bf16_t* __restrict__ Vb, float* __restrict__ T) {
    const int row = blockIdx.x * 256 + threadIdx.x, hm = blockIdx.y >> 2, chk = blockIdx.y & 3, h = hm >> 1;
    float q[64];
#pragma unroll
    for (int d = 0; d < 64; ++d) q[d] = bf2f(Q[(size_t)row * 512 + hm * 64 + d]);
    float o[32];
#pragma unroll
    for (int e = 0; e < 32; ++e) o[e] = 0.f;
    float m = -1e30f, l = 0.f;
    const bf16_t* Kp = Kb + hm * 64; const bf16_t* Vp = Vb + h * 128 + chk * 32;
    for (int j = 0; j < S; ++j) {
        const uint4* kr = (const uint4*)(Kp + (size_t)j * 512);
        float s = 0.f;
#pragma unroll
        for (int i = 0; i < 8; ++i) { const uint4 w = kr[i];
            s += q[i * 8 + 0] * __uint_as_float(w.x << 16) + q[i * 8 + 1] * __uint_as_float(w.x & 0xffff0000u);
            s += q[i * 8 + 2] * __uint_as_float(w.y << 16) + q[i * 8 + 3] * __uint_as_float(w.y & 0xffff0000u);
            s += q[i * 8 + 4] * __uint_as_float(w.z << 16) + q[i * 8 + 5] * __uint_as_float(w.z & 0xffff0000u);
            s += q[i * 8 + 6] * __uint_as_float(w.w << 16) + q[i * 8 + 7] * __uint_as_float(w.w & 0xffff0000u); }
        const float mn = fmaxf(m, s), a = exp2f(m - mn), p = exp2f(s - mn);
        l = l * a + p; m = mn;
        const uint4* vr = (const uint4*)(Vp + (size_t)j * 512);
#pragma unroll
        for (int i = 0; i < 4; ++i) { const uint4 w = vr[i];
            o[i * 8 + 0] = o[i * 8 + 0] * a + p * __uint_as_float(w.x << 16); o[i * 8 + 1] = o[i * 8 + 1] * a + p * __uint_as_float(w.x & 0xffff0000u);
            o[i * 8 + 2] = o[i * 8 + 2] * a + p * __uint_as_float(w.y << 16); o[i * 8 + 3] = o[i * 8 + 3] * a + p * __uint_as_float(w.y & 0xffff0000u);
            o[i * 8 + 4] = o[i * 8 + 4] * a + p * __uint_as_float(w.z << 16); o[i * 8 + 5] = o[i * 8 + 5] * a + p * __uint_as_float(w.z & 0xffff0000u);
            o[i * 8 + 6] = o[i * 8 + 6] * a + p * __uint_as_float(w.w << 16); o[i * 8 + 7] = o[i * 8 + 7] * a + p * __uint_as_float(w.w & 0xffff0000u); }
    }
    const float rl = 1.f / l;
    float* Tp = T + ((size_t)(row * 4 + h) * 2 + (hm & 1)) * 128 + chk * 32;
#pragma unroll
    for (int e = 0; e < 32; ++e) Tp[e] = o[e] * rl;
}
__global__ __launch_bounds__(256) void k_attn_combine(const float* __restrict__ T, const float* __restrict__ lq1, const float* __restrict__ lk1,
                                                      const float* __restrict__ lq2, const float* __restrict__ lk2, const float* __restrict__ sg, bf16_t* __restrict__ A2) {
    const int lane = threadIdx.x & 63, rh = blockIdx.x * 4 + (threadIdx.x >> 6);
    float s1 = lq1[lane] * lk1[lane], s2 = lq2[lane] * lk2[lane];
#pragma unroll
    for (int o = 1; o < 64; o <<= 1) { s1 += __shfl_xor(s1, o); s2 += __shfl_xor(s2, o); }
    const float lam = expf(s1) - expf(s2) + LAM_INIT;
    const float* T0 = T + (size_t)rh * 256; const float* T1 = T0 + 128;
    const float a0 = T0[lane] - lam * T1[lane], a1 = T0[lane + 64] - lam * T1[lane + 64];
    float q = a0 * a0 + a1 * a1;
#pragma unroll
    for (int o = 1; o < 64; o <<= 1) q += __shfl_xor(q, o);
    const float r = 1.f / sqrtf(q * (1.f / 128.f) + LN_EPS) * (1.f - LAM_INIT);
    const int row = rh >> 2, h = rh & 3;
    A2[(size_t)row * D + 512 + h * 128 + lane] = (bf16_t)f2bf(a0 * r * sg[lane]);
    A2[(size_t)row * D + 512 + h * 128 + lane + 64] = (bf16_t)f2bf(a1 * r * sg[lane + 64]);
}

extern "C" void kernel_launch(void* const* d_in, const int* in_sizes, int n_in, void* d_out, int out_size, void* d_ws, size_t ws_size, hipStream_t stream) {
    if (n_in != 25 || in_sizes[0] != S * D || out_size != S * D || ws_size < WS_END) { fprintf(stderr, "kernel_launch: unexpected shapes (n_in %d, in0 %d, out %d, ws %zu)\n", n_in, n_in > 0 ? in_sizes[0] : -1, out_size, ws_size); return; }
    const float* x = (const float*)d_in[0]; const float* c = (const float*)d_in[1]; const float* w_ada = (const float*)d_in[2]; const float* b_ada = (const float*)d_in[3];
    const float* f1_in = (const float*)d_in[4]; const float* f1_out = (const float*)d_in[5]; const float* ln1_g = (const float*)d_in[6]; const float* ln1_b = (const float*)d_in[7];
    const float* mix_in = (const float*)d_in[8]; const float* conv_w = (const float*)d_in[9]; const float* conv_b = (const float*)d_in[10];
    const float* cln_g = (const float*)d_in[11]; const float* cln_b = (const float*)d_in[12];
    const float* lq1 = (const float*)d_in[13]; const float* lk1 = (const float*)d_in[14]; const float* lq2 = (const float*)d_in[15]; const float* lk2 = (const float*)d_in[16];
    const float* subln_g = (const float*)d_in[17]; const float* mix_out = (const float*)d_in[18]; const float* ln2_g = (const float*)d_in[19]; const float* ln2_b = (const float*)d_in[20];
    const float* f2_in = (const float*)d_in[21]; const float* f2_out = (const float*)d_in[22]; const float* ln3_g = (const float*)d_in[23]; const float* ln3_b = (const float*)d_in[24];
    char* ws = (char*)d_ws; float* out = (float*)d_out;
    float* mod = (float*)(ws + WS_MOD); float* ct = (float*)(ws + WS_COS); float* st = (float*)(ws + WS_SIN);
    bf16_t* H = (bf16_t*)(ws + WS_H); bf16_t* ACT = (bf16_t*)(ws + WS_ACT);
    bf16_t* U = (bf16_t*)(ws + WS_U); bf16_t* Q = (bf16_t*)(ws + WS_Q); bf16_t* Kb = (bf16_t*)(ws + WS_K); bf16_t* Vb = (bf16_t*)(ws + WS_V); bf16_t* A2 = (bf16_t*)(ws + WS_A2);
    float* NV = (float*)(ws + WS_NV);
#define MODP(sub, j) (mod + ((sub) * 3 + (j)) * D)
    k_mod<<<NMOD / 256, 256, 0, stream>>>(c, w_ada, b_ada, mod);
    k_rope<<<S * 8 / 256, 256, 0, stream>>>(ct, st);
    k_modulate<<<S * D / 256, 256, 0, stream>>>(x, MODP(0, 0), MODP(0, 1), H);
    gemm_naive<true, EpiSwiglu><<<dim3(FF / 64, S / 64), 256, 0, stream>>>(H, D, f1_in, 2 * FF, 0, FF, EpiSwiglu{ACT});
    gemm_naive<false, EpiF32><<<dim3(D / 64, S / 64), 256, 0, stream>>>(ACT, FF, f1_out, D, 0, 0, EpiF32{NV, D, 0});
    k_ln<<<S / 4, 256, 0, stream>>>(x, NV, MODP(0, 2), 0.5f, ln1_g, ln1_b, out, MODP(1, 0), MODP(1, 1), H);
    gemm_naive<true, EpiGlu><<<dim3(CW / 64, S / 64), 256, 0, stream>>>(H, D, mix_in, NMIX, 0, CW, EpiGlu{U});
    gemm_naive<false, EpiF32><<<dim3(1024 / 64, S / 64), 256, 0, stream>>>(H, D, mix_in, NMIX, 2 * CW, 0, EpiF32{NV, 1024, 0});
    gemm_naive<false, EpiBf><<<dim3(AW / 64, S / 64), 256, 0, stream>>>(H, D, mix_in, NMIX, 2 * CW + 2 * AW, 0, EpiBf{Vb, 512, 0});
    k_ropeqk<<<S * 1024 / 256, 256, 0, stream>>>(NV, ct, st, Q, Kb);
    k_conv<<<S, 256, 0, stream>>>(U, conv_w, conv_b, cln_g, cln_b, A2);
    k_attn<<<dim3(S / 256, 32), 256, 0, stream>>>(Q, Kb, Vb, NV);
    k_attn_combine<<<S * 4 / 4, 256, 0, stream>>>(NV, lq1, lk1, lq2, lk2, subln_g, A2);
    gemm_naive<false, EpiF32><<<dim3(D / 64, S / 64), 256, 0, stream>>>(A2, D, mix_out, D, 0, 0, EpiF32{NV, D, 0});
    k_ln<<<S / 4, 256, 0, stream>>>(out, NV, MODP(1, 2), 1.0f, ln2_g, ln2_b, out, MODP(2, 0), MODP(2, 1), H);
    gemm_naive<true, EpiSwiglu><<<dim3(FF / 64, S / 64), 256, 0, stream>>>(H, D, f2_in, 2 * FF, 0, FF, EpiSwiglu{ACT});
    gemm_naive<false, EpiF32><<<dim3(D / 64, S / 64), 256, 0, stream>>>(ACT, FF, f2_out, D, 0, 0, EpiF32{NV, D, 0});
    k_ln<<<S / 4, 256, 0, stream>>>(out, NV, MODP(2, 2), 0.5f, ln3_g, ln3_b, out, nullptr, nullptr, nullptr);
#undef MODP
}
```
